# Optimizing an MI355X kernel written in HIP

```python
import jax, jax.numpy as jnp
from jax import lax
import numpy as np

D_MODEL = 1024
BATCH = 8
SEQ = 4096
DEPTH = 2

N_A_LAYERS = DEPTH // 2
N_B_LAYERS = DEPTH - N_A_LAYERS
D_FF = 2816
D_RNN = 1344
N_LRU_BLOCKS = 16
LRU_BLOCK = D_RNN // N_LRU_BLOCKS
CONV_WIDTH = 4
LRU_C = 8.0
N_HEADS = 16
HEAD_DIM = 64
D_ATTN = N_HEADS * HEAD_DIM
Q_BLOCK = 128
EPS = 1e-6

kernel_name = "yoco_rglru_forgetting_attention_macaron"


def rms_norm(x, g):
    xf = x.astype(jnp.float32)
    y = xf * lax.rsqrt(jnp.mean(xf * xf, axis=-1, keepdims=True) + EPS)
    return (y * g.astype(jnp.float32)).astype(x.dtype)


def swiglu(x, w_gate, w_up, w_down):
    return (jax.nn.silu(x @ w_gate) * (x @ w_up)) @ w_down


def causal_depthwise_conv(x, w, b):
    S = x.shape[1]
    xp = jnp.pad(x, ((0, 0), (CONV_WIDTH - 1, 0), (0, 0)))
    y = b
    for k in range(CONV_WIDTH):
        y = y + xp[:, k:k + S] * w[k]
    return y


def rg_lru(x, w_a, b_a, w_x, b_x, lam):
    Bn, S, _ = x.shape
    xb = x.reshape(Bn, S, N_LRU_BLOCKS, LRU_BLOCK)
    r = jax.nn.sigmoid(jnp.einsum('bsnc,ncd->bsnd', xb, w_a).reshape(Bn, S, D_RNN) + b_a)
    i = jax.nn.sigmoid(jnp.einsum('bsnc,ncd->bsnd', xb, w_x).reshape(Bn, S, D_RNN) + b_x)
    log_a = -LRU_C * r.astype(jnp.float32) * jax.nn.softplus(-lam.astype(jnp.float32))
    a = jnp.exp(log_a)
    u = jnp.sqrt(-jnp.expm1(2.0 * log_a)) * (i * x).astype(jnp.float32)

    def combine(c1, c2):
        a1, b1 = c1
        a2, b2 = c2
        return a1 * a2, a2 * b1 + b2

    _, h = lax.associative_scan(combine, (a, u), axis=1)
    return h.astype(x.dtype)


def recurrent_block(x, w_in, conv_w, conv_b, w_a, b_a, w_x, b_x, lam, w_out):
    gx = x @ w_in
    gate, rec = gx[..., :D_RNN], gx[..., D_RNN:]
    rec = causal_depthwise_conv(rec, conv_w, conv_b)
    rec = rg_lru(rec, w_a, b_a, w_x, b_x, lam)
    return (jax.nn.gelu(gate) * rec) @ w_out


def shared_kv(h, g, w_kv, w_f, b_f):
    Bn, S, _ = h.shape
    hn = rms_norm(h, g)
    kv = (hn @ w_kv).reshape(Bn, S, 2, N_HEADS, HEAD_DIM)
    k = kv[:, :, 0].transpose(0, 2, 1, 3)
    v = kv[:, :, 1].transpose(0, 2, 1, 3)
    log_f = jax.nn.log_sigmoid((hn @ w_f + b_f).astype(jnp.float32))
    c = jnp.cumsum(log_f, axis=1).transpose(0, 2, 1)
    return k, v, c


def forgetting_attention(xq, w_q, w_o, k, v, c):
    Bn, S, _ = xq.shape
    q = (xq @ w_q).reshape(Bn, S, N_HEADS, HEAD_DIM).transpose(0, 2, 1, 3) * (HEAD_DIM ** -0.5)
    outs = []
    for blk in range(S // Q_BLOCK):
        q0 = blk * Q_BLOCK
        end = q0 + Q_BLOCK
        logits = jnp.einsum('bhqd,bhkd->bhqk', q[:, :, q0:end], k[:, :, :end]).astype(jnp.float32)
        logits = logits + c[:, :, q0:end, None] - c[:, :, None, :end]
        qpos = q0 + jnp.arange(Q_BLOCK)
        kpos = jnp.arange(end)
        logits = jnp.where(kpos[None, :] <= qpos[:, None], logits, -jnp.inf)
        p = jax.nn.softmax(logits, axis=-1).astype(v.dtype)
        outs.append(jnp.einsum('bhqk,bhkd->bhqd', p, v[:, :, :end]))
    o = jnp.concatenate(outs, axis=2).transpose(0, 2, 1, 3).reshape(Bn, S, D_ATTN)
    return o @ w_o


def setup_inputs(seed: int = 0) -> dict:
    key = jax.random.key(seed)
    ks = iter(jax.random.split(key, 40))
    f32 = jnp.float32

    def nrm(shape, fan_in):
        return jax.random.normal(next(ks), shape, f32) * (fan_in ** -0.5)

    def gain(shape):
        return 1.0 + 0.05 * jax.random.normal(next(ks), shape, f32)

    def small(shape):
        return 0.02 * jax.random.normal(next(ks), shape, f32)

    L, NA, NB = DEPTH, N_A_LAYERS, N_B_LAYERS
    x = jax.random.normal(next(ks), (BATCH, SEQ, D_MODEL), f32)
    u = jax.random.uniform(next(ks), (NA, D_RNN), f32, minval=0.9, maxval=0.999)
    a0 = u ** (1.0 / LRU_C)
    rg_lambda = jnp.log(a0) - jnp.log1p(-a0)
    return {
        "x": x,
        "ffn1_pre_g": gain((L, D_MODEL)),
        "ffn1_w_gate": nrm((L, D_MODEL, D_FF), D_MODEL),
        "ffn1_w_up": nrm((L, D_MODEL, D_FF), D_MODEL),
        "ffn1_w_down": nrm((L, D_FF, D_MODEL), D_FF),
        "ffn1_post_g": gain((L, D_MODEL)),
        "mix_pre_g": gain((L, D_MODEL)),
        "mix_post_g": gain((L, D_MODEL)),
        "ffn2_pre_g": gain((L, D_MODEL)),
        "ffn2_w_gate": nrm((L, D_MODEL, D_FF), D_MODEL),
        "ffn2_w_up": nrm((L, D_MODEL, D_FF), D_MODEL),
        "ffn2_w_down": nrm((L, D_FF, D_MODEL), D_FF),
        "ffn2_post_g": gain((L, D_MODEL)),
        "rg_w_in": nrm((NA, D_MODEL, 2 * D_RNN), D_MODEL),
        "rg_conv_w": nrm((NA, CONV_WIDTH, D_RNN), CONV_WIDTH),
        "rg_conv_b": small((NA, D_RNN)),
        "rg_w_a": nrm((NA, N_LRU_BLOCKS, LRU_BLOCK, LRU_BLOCK), LRU_BLOCK),
        "rg_b_a": small((NA, D_RNN)),
        "rg_w_x": nrm((NA, N_LRU_BLOCKS, LRU_BLOCK, LRU_BLOCK), LRU_BLOCK),
        "rg_b_x": small((NA, D_RNN)),
        "rg_lambda": rg_lambda,
        "rg_w_out": nrm((NA, D_RNN, D_MODEL), D_RNN),
        "kv_norm_g": gain((D_MODEL,)),
        "w_kv": nrm((D_MODEL, 2 * D_ATTN), D_MODEL),
        "w_fgate": nrm((D_MODEL, N_HEADS), D_MODEL),
        "b_fgate": jax.random.uniform(next(ks), (N_HEADS,), f32, minval=1.0, maxval=4.0),
        "attn_w_q": nrm((NB, D_MODEL, D_ATTN), D_MODEL),
        "attn_w_o": nrm((NB, D_ATTN, D_MODEL), D_ATTN),
    }


def reference(x, ffn1_pre_g, ffn1_w_gate, ffn1_w_up, ffn1_w_down, ffn1_post_g,
              mix_pre_g, mix_post_g,
              ffn2_pre_g, ffn2_w_gate, ffn2_w_up, ffn2_w_down, ffn2_post_g,
              rg_w_in, rg_conv_w, rg_conv_b, rg_w_a, rg_b_a, rg_w_x, rg_b_x, rg_lambda, rg_w_out,
              kv_norm_g, w_kv, w_fgate, b_fgate, attn_w_q, attn_w_o):
    h = x
    k = v = c = None
    for layer in range(DEPTH):
        if layer == N_A_LAYERS:
            k, v, c = shared_kv(h, kv_norm_g, w_kv, w_fgate, b_fgate)
        f = swiglu(rms_norm(h, ffn1_pre_g[layer]), ffn1_w_gate[layer], ffn1_w_up[layer], ffn1_w_down[layer])
        h = h + 0.5 * rms_norm(f, ffn1_post_g[layer])
        hn = rms_norm(h, mix_pre_g[layer])
        if layer < N_A_LAYERS:
            j = layer
            m = recurrent_block(hn, rg_w_in[j], rg_conv_w[j], rg_conv_b[j], rg_w_a[j], rg_b_a[j],
                                rg_w_x[j], rg_b_x[j], rg_lambda[j], rg_w_out[j])
        else:
            j = layer - N_A_LAYERS
            m = forgetting_attention(hn, attn_w_q[j], attn_w_o[j], k, v, c)
        h = h + rms_norm(m, mix_post_g[layer])
        f = swiglu(rms_norm(h, ffn2_pre_g[layer]), ffn2_w_gate[layer], ffn2_w_up[layer], ffn2_w_down[layer])
        h = h + 0.5 * rms_norm(f, ffn2_post_g[layer])
    return h
```

```cpp
#include <hip/hip_runtime.h>
#include <cstdio>
#include <cstdint>
namespace pg8 {
#define PG8_LAS __attribute__((address_space(3)))
typedef unsigned short bf16_t;
typedef short bf16x8 __attribute__((ext_vector_type(8)));
typedef float f32x4 __attribute__((ext_vector_type(4)));
typedef unsigned u32x4 __attribute__((ext_vector_type(4)));
constexpr int BM = 256, BK = 64, HALF = 128, HTB = HALF * BK * 2  , STAGE_BYTES = 8 * HTB, NXCD = 8, WGM = 8;

__host__ __device__ __forceinline__ int lds_byte(int r, int c) { const int st = (r >> 4) * 2 + (c >> 5), rr = r & 15, cc = c & 31, ob = rr * 64 + cc * 2; return st * 1024 + (ob ^ (((ob >> 9) & 1) << 5)); }
__host__ __device__ __forceinline__ void stage_rc(int b, int& R, int& C) { const int st = b / 1024, sb = b % 1024, swz = sb ^ (((sb >> 9) & 1) << 5); R = (st >> 1) * 16 + swz / 64; C = (st & 1) * 32 + (swz % 64) / 2; }
__host__ __device__ __forceinline__ int perm32(int rho) { const int n = rho >> 4, i = rho & 15; return 8 * (i >> 2) + 4 * n + (i & 3); }

struct Unit { int pm, pn; };
struct Gemm { const bf16_t* A; const bf16_t* Bt; int M, N, K, lda, ldb; };

struct StaticOrder {
    int nM, nN, nwg, G, c;
    __host__ __device__ void init(int M, int N, int G_, int c_) { nM = M / BM; nN = N / BM; nwg = nM * nN; G = G_; c = c_; }
    __host__ __device__ bool next(int i, Unit& u) const {
        const long L = (long)i * G + c; if (L >= nwg) return false;
        int wgid = (int)L; { const int q = nwg / NXCD, r = nwg % NXCD, xcd = wgid % NXCD, off = wgid / NXCD; wgid = (xcd < r ? xcd * (q + 1) : r * (q + 1) + (xcd - r) * q) + off; }
        const int nig = WGM * nN, gid = wgid / nig, fm = gid * WGM, gsz = (nM - fm) < WGM ? (nM - fm) : WGM;
        u.pm = fm + ((wgid % nig) % gsz); u.pn = (wgid % nig) / gsz; return true;
    }
    __device__ __forceinline__ void a_ready(const Unit&) const {}
    __device__ __forceinline__ void done(const Unit&) const {}
};

__device__ __forceinline__ unsigned cvt_pk_bf16(float lo, float hi) { unsigned r; asm volatile("v_cvt_pk_bf16_f32 %0, %1, %2" : "=v"(r) : "v"(lo), "v"(hi)); return r; }
typedef float f32x2 __attribute__((ext_vector_type(2)));
__device__ __forceinline__ f32x2 gelu_pk(f32x2 v) {
    const f32x2 av = __builtin_elementwise_abs(v), d = av * 0.2316418882f + 1.0f;
    f32x2 t; t.x = __builtin_amdgcn_rcpf(d.x); t.y = __builtin_amdgcn_rcpf(d.y);
    f32x2 q = t * 0.5307027145f + (-0.7265760135f); q = q * t + 0.7107068705f; q = q * t + (-0.142248368f); q = q * t + 0.127414796f; q = q * t;
    const f32x2 s = (v * v) * (-0.72134752044f);
    f32x2 e; e.x = __builtin_amdgcn_exp2f(s.x); e.y = __builtin_amdgcn_exp2f(s.y);
    const f32x2 m = v * (q * e), r = v - m;
    f32x2 o; o.x = v.x < 0.f ? m.x : r.x; o.y = v.y < 0.f ? m.y : r.y; return o;
}

template <int ACT  > struct EpiBf16 {
    static constexpr bool PERM = true, AFTER_DRAIN = false; static_assert(ACT == 0 || ACT == 1, "EpiBf16: ACT is 0 (none) or 1 (gelu_pk)");
    bf16_t* O; int ldc; const float* bias; int split_cols; size_t split_stride; float scale0;
    __device__ __forceinline__ void operator()(const f32x4 (&acc)[2][2][4][2], const Unit& u, int wr, int wc, int fr, int fq) const {
        const int row0 = u.pm * BM + wr * 64 + fr; int colt = u.pn * BM; bf16_t* base = O;
        float sc = 1.f; if (split_cols) { const int t = colt / split_cols; base += (size_t)t * split_stride; colt -= t * split_cols; if (t == 0) sc = scale0; }
        const int col0 = colt + wc * 32 + 8 * fq, bcol0 = u.pn * BM + wc * 32 + 8 * fq;
        f32x4 bv[2][2];
#pragma unroll
        for (int bj = 0; bj < 2; ++bj)
#pragma unroll
            for (int n = 0; n < 2; ++n) bv[bj][n] = bias ? *(const f32x4*)(bias + bcol0 + bj * HALF + 4 * n) : (f32x4){0.f, 0.f, 0.f, 0.f};
#pragma unroll
        for (int ai = 0; ai < 2; ++ai)
#pragma unroll
            for (int m = 0; m < 4; ++m) { bf16_t* rowp = base + (size_t)(row0 + ai * HALF + m * 16) * ldc + col0;
#pragma unroll
                for (int bj = 0; bj < 2; ++bj) { f32x4 v0 = acc[ai][bj][m][0] + bv[bj][0], v1 = acc[ai][bj][m][1] + bv[bj][1];
                    if (ACT == 1) { f32x2 a = gelu_pk((f32x2){v0[0], v0[1]}), b = gelu_pk((f32x2){v0[2], v0[3]}), c = gelu_pk((f32x2){v1[0], v1[1]}), d = gelu_pk((f32x2){v1[2], v1[3]});
                        v0 = (f32x4){a.x, a.y, b.x, b.y}; v1 = (f32x4){c.x, c.y, d.x, d.y}; }
                    v0 = v0 * sc; v1 = v1 * sc; u32x4 w; w.x = cvt_pk_bf16(v0[0], v0[1]); w.y = cvt_pk_bf16(v0[2], v0[3]); w.z = cvt_pk_bf16(v1[0], v1[1]); w.w = cvt_pk_bf16(v1[2], v1[3]);
                    *(u32x4*)(rowp + bj * HALF) = w; } }
    }
};

template <class Epi, class Sched, bool ALIGN_EPI = false, bool SP2 = false>
__device__ __forceinline__ void gemm_phase(PG8_LAS unsigned char* lds, const Gemm g, const Sched& S, const Epi& E) {
    const int tid = threadIdx.x, wid = __builtin_amdgcn_readfirstlane(tid >> 6), lane = tid & 63, wr = wid >> 2, wc = wid & 3, fr = lane & 15, fq = lane >> 4;
    const int K = g.K, nt = K / BK;
    unsigned voffA[2], voffB[2];
#pragma unroll
    for (int i = 0; i < 2; ++i) { int R, C; stage_rc(tid * 16 + i * 8192, R, C); const int Rb = Epi::PERM ? ((R & ~31) + perm32(R & 31)) : R;
        voffA[i] = (unsigned)(R * g.lda + C) * 2u; voffB[i] = (unsigned)(Rb * g.ldb + C) * 2u; }
    const size_t kstep = (size_t)(BK * 2);
    const size_t hstepA = (size_t)HALF * g.lda * 2, hstepB = (size_t)HALF * g.ldb * 2;
    const size_t tstepA = 2 * hstepA, tstepB = 2 * hstepB;
    const unsigned ldsw = (unsigned)wid * 1024u;
    const int aoff = lds_byte(wr * 64 + fr, fq * 8), boff = lds_byte(wc * 32 + fr, fq * 8);
#define PG8_SA(b, h) (((b) * 2 + (h)) * HTB)
#define PG8_SB(b, h) ((4 + (b) * 2 + (h)) * HTB)
#define PG8_STAGE(bufoff, gbase, voff) do { _Pragma("unroll") for (int _i = 0; _i < 2; ++_i) \
        __builtin_amdgcn_global_load_lds((const unsigned*)((const char*)(gbase) + (voff)[_i]), (PG8_LAS unsigned*)(lds + (bufoff) + ldsw + _i * 8192), 16, 0, 0); } while (0)
#define PG8_LDA(dst, b, h) do { _Pragma("unroll") for (int m = 0; m < 4; ++m) _Pragma("unroll") for (int k = 0; k < 2; ++k) dst[m][k] = *(const PG8_LAS bf16x8*)(lds + PG8_SA(b, h) + aoff + m * 2048 + k * 1024); } while (0)
#define PG8_LDB(dst, b, h) do { _Pragma("unroll") for (int n = 0; n < 2; ++n) _Pragma("unroll") for (int k = 0; k < 2; ++k) dst[n][k] = *(const PG8_LAS bf16x8*)(lds + PG8_SB(b, h) + boff + n * 2048 + k * 1024); } while (0)
#define PG8_MMA(ai, bj, At, Bt) do { __builtin_amdgcn_s_setprio(1); _Pragma("unroll") for (int m = 0; m < 4; ++m) _Pragma("unroll") for (int n = 0; n < 2; ++n) _Pragma("unroll") for (int k = 0; k < 2; ++k) \
        acc[ai][bj][m][n] = __builtin_amdgcn_mfma_f32_16x16x32_bf16(Bt[n][k], At[m][k], acc[ai][bj][m][n], 0, 0, 0); __builtin_amdgcn_s_setprio(0); } while (0)
#define PG8_WAIT_V(n) asm volatile("s_waitcnt vmcnt(" #n ")" ::: "memory")
#define PG8_WAIT_L(n) asm volatile("s_waitcnt lgkmcnt(" #n ")" ::: "memory")
#define PG8_BAR __builtin_amdgcn_s_barrier()
#define PG8_SCHED __builtin_amdgcn_sched_barrier(0)
    Unit cur, nxt; int ui = 0;
    if (!S.next(0, cur)) return;
    f32x4 acc[2][2][4][2];
#pragma unroll
    for (int a = 0; a < 2; ++a)
#pragma unroll
        for (int b = 0; b < 2; ++b)
#pragma unroll
            for (int m = 0; m < 4; ++m)
#pragma unroll
                for (int n = 0; n < 2; ++n) acc[a][b][m][n] = (f32x4){0.f, 0.f, 0.f, 0.f};
    bf16x8 At[4][2], B0[2][2], B1[2][2];
    const char* cA = (const char*)g.A + (size_t)cur.pm * tstepA; const char* cB = (const char*)g.Bt + (size_t)cur.pn * tstepB;
    S.a_ready(cur);
    if constexpr (SP2) {
        PG8_STAGE(PG8_SB(0, 0), cB, voffB); PG8_STAGE(PG8_SB(0, 1), cB + hstepB, voffB); PG8_STAGE(PG8_SA(0, 0), cA, voffA); PG8_STAGE(PG8_SA(0, 1), cA + hstepA, voffA);
        if (wr == 1) PG8_BAR;
        PG8_WAIT_V(2); PG8_BAR;
        PG8_STAGE(PG8_SB(1, 0), cB + kstep, voffB); PG8_STAGE(PG8_SA(1, 0), cA + kstep, voffA); PG8_STAGE(PG8_SB(1, 1), cB + hstepB + kstep, voffB);
        PG8_WAIT_V(6); PG8_BAR;
    } else {
        PG8_STAGE(PG8_SB(0, 0), cB, voffB); PG8_STAGE(PG8_SA(0, 0), cA, voffA); PG8_STAGE(PG8_SB(0, 1), cB + hstepB, voffB); PG8_STAGE(PG8_SA(0, 1), cA + hstepA, voffA);
        if (wr == 1) PG8_BAR;
        PG8_WAIT_V(4); PG8_BAR;
        PG8_STAGE(PG8_SB(1, 0), cB + kstep, voffB); PG8_STAGE(PG8_SA(1, 0), cA + kstep, voffA); PG8_STAGE(PG8_SB(1, 1), cB + hstepB + kstep, voffB);
        PG8_WAIT_V(6); PG8_BAR;
    }
    for (;;) {
        const bool has_next = S.next(ui + 1, nxt);
        const char* nA = has_next ? (const char*)g.A + (size_t)nxt.pm * tstepA : cA; const char* nB = has_next ? (const char*)g.Bt + (size_t)nxt.pn * tstepB : cB;
        for (int t = 0; t < nt; t += 2) {
            const bool last = (t == nt - 2);
            const char* a1 = cA + (size_t)(t + 1) * kstep;
            const char* a2 = last ? nA : cA + (size_t)(t + 2) * kstep; const char* b2 = last ? nB : cB + (size_t)(t + 2) * kstep;
            const char* a3 = a2 + kstep; const char* b3 = b2 + kstep;
            if (last && has_next) S.a_ready(nxt);
            if constexpr (SP2) {
            PG8_LDB(B0, 0, 0); PG8_LDB(B1, 0, 1); PG8_SCHED; PG8_LDA(At, 0, 0); PG8_STAGE(PG8_SA(1, 1), a1 + hstepA, voffA);
            PG8_WAIT_V(8); PG8_WAIT_L(0); PG8_BAR; PG8_MMA(0, 0, At, B0); PG8_MMA(0, 1, At, B1); PG8_BAR; PG8_SCHED;
            PG8_LDA(At, 0, 1); PG8_STAGE(PG8_SB(0, 0), b2, voffB); PG8_STAGE(PG8_SB(0, 1), b2 + hstepB, voffB); PG8_STAGE(PG8_SA(0, 0), a2, voffA);
            PG8_WAIT_V(8); PG8_WAIT_L(0); PG8_BAR; PG8_MMA(1, 0, At, B0); PG8_MMA(1, 1, At, B1); PG8_BAR; PG8_SCHED;
            PG8_LDB(B0, 1, 0); PG8_LDB(B1, 1, 1); PG8_SCHED; PG8_LDA(At, 1, 0); PG8_STAGE(PG8_SA(0, 1), a2 + hstepA, voffA);
            PG8_WAIT_V(8); PG8_WAIT_L(0); PG8_BAR; PG8_MMA(0, 0, At, B0); PG8_MMA(0, 1, At, B1); PG8_BAR; PG8_SCHED;
            PG8_LDA(At, 1, 1); PG8_STAGE(PG8_SB(1, 0), b3, voffB); PG8_STAGE(PG8_SB(1, 1), b3 + hstepB, voffB); PG8_STAGE(PG8_SA(1, 0), a3, voffA);
            PG8_WAIT_V(8); PG8_WAIT_L(0); PG8_BAR; PG8_MMA(1, 0, At, B0); PG8_MMA(1, 1, At, B1); PG8_BAR; PG8_SCHED;
            } else {
            PG8_LDB(B0, 0, 0); PG8_SCHED; PG8_LDA(At, 0, 0); PG8_STAGE(PG8_SA(1, 1), a1 + hstepA, voffA);
            PG8_WAIT_L(8); PG8_BAR; PG8_WAIT_L(0); PG8_MMA(0, 0, At, B0); PG8_BAR; PG8_SCHED;
            PG8_LDB(B1, 0, 1); PG8_STAGE(PG8_SB(0, 0), b2, voffB);
            PG8_BAR; PG8_WAIT_L(0); PG8_MMA(0, 1, At, B1); PG8_BAR;
            PG8_LDA(At, 0, 1); PG8_STAGE(PG8_SA(0, 0), a2, voffA);
            PG8_BAR; PG8_WAIT_L(0); PG8_MMA(1, 0, At, B0); PG8_BAR; PG8_SCHED;
            PG8_STAGE(PG8_SB(0, 1), b2 + hstepB, voffB);
            PG8_WAIT_V(6); PG8_BAR; PG8_MMA(1, 1, At, B1); PG8_BAR;
            PG8_LDB(B0, 1, 0); PG8_SCHED; PG8_LDA(At, 1, 0); PG8_STAGE(PG8_SA(0, 1), a2 + hstepA, voffA);
            PG8_WAIT_L(8); PG8_BAR; PG8_WAIT_L(0); PG8_MMA(0, 0, At, B0); PG8_BAR; PG8_SCHED;
            PG8_LDB(B1, 1, 1); PG8_STAGE(PG8_SB(1, 0), b3, voffB);
            PG8_BAR; PG8_WAIT_L(0); PG8_MMA(0, 1, At, B1); PG8_BAR;
            PG8_LDA(At, 1, 1); PG8_STAGE(PG8_SA(1, 0), a3, voffA);
            PG8_BAR; PG8_WAIT_L(0); PG8_MMA(1, 0, At, B0); PG8_BAR; PG8_SCHED;
            PG8_STAGE(PG8_SB(1, 1), b3 + hstepB, voffB);
            PG8_WAIT_V(6); PG8_BAR; PG8_MMA(1, 1, At, B1); PG8_BAR;
            }
        }
        if constexpr (ALIGN_EPI) { if (wr == 0) PG8_BAR; }
        if constexpr (!Epi::AFTER_DRAIN) { E(acc, cur, wr, wc, fr, fq); S.done(cur); }
        if (!has_next) break;
#pragma unroll
        for (int a = 0; a < 2; ++a)
#pragma unroll
            for (int b = 0; b < 2; ++b)
#pragma unroll
                for (int m = 0; m < 4; ++m)
#pragma unroll
                    for (int n = 0; n < 2; ++n) acc[a][b][m][n] = (f32x4){0.f, 0.f, 0.f, 0.f};
        cur = nxt; cA = nA; cB = nB; ++ui;
        if constexpr (ALIGN_EPI) { if (wr == 1) PG8_BAR; }
    }
    PG8_WAIT_V(0);
    if constexpr (!ALIGN_EPI) { if (wr == 0) PG8_BAR; }
    PG8_BAR;
    if constexpr (Epi::AFTER_DRAIN) { E.fused(acc, cur, wr, wc, fr, fq, lds, wid, lane); S.done(cur); }
#undef PG8_SA
#undef PG8_SB
#undef PG8_STAGE
#undef PG8_LDA
#undef PG8_LDB
#undef PG8_MMA
#undef PG8_WAIT_V
#undef PG8_WAIT_L
#undef PG8_BAR
#undef PG8_SCHED
}
}

#ifndef PG8_SP2
#define PG8_SP2 true
#endif
#ifndef PG8_ALIGN
#define PG8_ALIGN true
#endif
#include <hip/hip_bf16.h>
#include <cmath>
namespace attn_body {
using bf16=__hip_bfloat16;
using bf16x8=__attribute__((ext_vector_type(8)))short;
using s16x4=__attribute__((ext_vector_type(4)))short;
using f32x16=__attribute__((ext_vector_type(16)))float;
using u32x4=__attribute__((ext_vector_type(4)))unsigned;
using f32x4v=__attribute__((ext_vector_type(4)))float;
constexpr int BATCH=8,NHEAD=16,SEQ=4096,D=64,DM=NHEAD*D;
constexpr int NW=8,QBLK=32,QB=QBLK*NW,KVBLK=64,NQB=SEQ/QB;
constexpr int ATTN_PITCH=DM, ATTN_UNIT_ROWS=QB;
__device__ __forceinline__ int crow(int r,int hi){return (r&3)+8*(r>>2)+4*hi;}
#define SBAR() __builtin_amdgcn_sched_barrier(0)
__device__ __forceinline__ void cmask(f32x16&p0,f32x16&p1,int jb,int qrel,int hi){
  const float NEG=-INFINITY; int kb=64*jb+4*hi;
  #pragma unroll
  for(int r=0;r<16;++r){int kv=kb+(r&3)+8*(r>>2); if(kv>qrel)p0[r]=NEG; if(kv+32>qrel)p1[r]=NEG;}
}

constexpr int NSLOT=3, SLOTB=8192;
constexpr int LDS_K=0, LDS_V=NSLOT*SLOTB, LDS_WS=2*NSLOT*SLOTB, LDS_OST=LDS_WS+NW*64*4, LDS_CB=LDS_OST+NW*4096, LDS_BYTES=LDS_CB+SEQ*4+64;
constexpr float C2=0.125f*1.4426950408889634f;
__device__ __forceinline__ void glds16(const void*gsrc,unsigned lds_dst){unsigned keep;
  asm volatile("s_mov_b32 %0, m0\n\ts_mov_b32 m0, %2\n\ts_nop 0\n\tglobal_load_lds_dwordx4 %1, off\n\ts_mov_b32 m0, %0":"=&s"(keep):"v"(gsrc),"s"(lds_dst):"memory");}
__device__ __forceinline__ float max3f(float a,float b,float c){float r;asm("v_max3_f32 %0, %1, %2, %3":"=v"(r):"v"(a),"v"(b),"v"(c));return r;}
__device__ __forceinline__ float max2f(float a,float b){float r;asm("v_max_f32_e32 %0, %1, %2":"=v"(r):"v"(a),"v"(b));return r;}
__device__ __forceinline__ float fadd_s(float a,float b){float r;asm("v_add_f32_e32 %0, %1, %2":"=v"(r):"v"(a),"v"(b));return r;}
__device__ __forceinline__ float fsub_s(float a,float b){float r;asm("v_sub_f32_e32 %0, %1, %2":"=v"(r):"v"(a),"v"(b));return r;}
typedef float f32x2_t __attribute__((ext_vector_type(2))); typedef __bf16 bf16x2_t __attribute__((ext_vector_type(2)));
__device__ __forceinline__ unsigned cvtpk_s(float lo,float hi){f32x2_t v={lo,hi};bf16x2_t b=__builtin_convertvector(v,bf16x2_t);return __builtin_bit_cast(unsigned,b);}
#define WAIT_BAR(N) asm volatile("s_waitcnt vmcnt(" #N ") lgkmcnt(0)\n\ts_barrier":::"memory")

__device__ __forceinline__ void qkt(f32x16&p0,f32x16&p1,const char*Kslot,const bf16x8*qr,int r32,int hi){
  const char*kb=Kslot+hi*1024+r32*16;
  #pragma unroll
  for(int d0=0;d0<4;++d0){
    const bf16x8 b0=*reinterpret_cast<const bf16x8*>(kb+d0*2048);
    const bf16x8 b1=*reinterpret_cast<const bf16x8*>(kb+d0*2048+512);
    {p0=__builtin_amdgcn_mfma_f32_32x32x16_bf16(b0,qr[d0],p0,0,0,0);p1=__builtin_amdgcn_mfma_f32_32x32x16_bf16(b1,qr[d0],p1,0,0,0);}}
}
typedef __attribute__((address_space(3))) const char* lds_cptr;
typedef short v4i16_t __attribute__((ext_vector_type(4)));
__device__ __forceinline__ void kload8(bf16x8*kf,lds_cptr kp){
  kf[0]=*(const __attribute__((address_space(3))) bf16x8*)(kp);      kf[1]=*(const __attribute__((address_space(3))) bf16x8*)(kp+512);
  kf[2]=*(const __attribute__((address_space(3))) bf16x8*)(kp+2048); kf[3]=*(const __attribute__((address_space(3))) bf16x8*)(kp+2560);
  kf[4]=*(const __attribute__((address_space(3))) bf16x8*)(kp+4096); kf[5]=*(const __attribute__((address_space(3))) bf16x8*)(kp+4608);
  kf[6]=*(const __attribute__((address_space(3))) bf16x8*)(kp+6144); kf[7]=*(const __attribute__((address_space(3))) bf16x8*)(kp+6656);
}
__device__ __forceinline__ void kload2(bf16x8*kf,lds_cptr kp,int j){ kf[2*j]=*(const __attribute__((address_space(3))) bf16x8*)(kp+j*2048); kf[2*j+1]=*(const __attribute__((address_space(3))) bf16x8*)(kp+j*2048+512); }
__device__ __forceinline__ s16x4 vtr(lds_cptr p){ return __builtin_bit_cast(s16x4,__builtin_amdgcn_ds_read_tr16_b64_v4i16((__attribute__((address_space(3))) v4i16_t*)p)); }
__device__ __forceinline__ float rowmax(const f32x16&p0,const f32x16&p1){
  float a=max3f(p0[0],p0[1],p1[0]),b=max3f(p0[2],p0[3],p1[1]);a=max3f(a,p1[2],p1[3]);
  #pragma unroll
  for(int r=4;r<16;r+=4){a=max3f(a,p0[r],p0[r+1]);b=max3f(b,p0[r+2],p0[r+3]);a=max3f(a,p1[r],p1[r+1]);b=max3f(b,p1[r+2],p1[r+3]);}
  const float m=max2f(a,b);
  auto rr=__builtin_amdgcn_permlane32_swap(__float_as_uint(m),__float_as_uint(m),false,false);
  return max2f(__uint_as_float(rr[0]),__uint_as_float(rr[1]));
}
__device__ __forceinline__ void pv(f32x16*o,int vb,bf16x8 pa0,bf16x8 pa1,bf16x8 pa2,bf16x8 pa3){
  #pragma unroll
  for(int d0=0;d0<2;++d0){s16x4 lo[4],hi[4];
    #pragma unroll
    for(int ks=0;ks<4;++ks){
      asm volatile("ds_read_b64_tr_b16 %0,%1 offset:%c2":"=&v"(lo[ks]):"v"(vb),"i"(d0*4096+ks*1024):"memory");
      asm volatile("ds_read_b64_tr_b16 %0,%1 offset:%c2":"=&v"(hi[ks]):"v"(vb),"i"(d0*4096+ks*1024+512):"memory");}
    asm volatile("s_waitcnt lgkmcnt(0)":::"memory");SBAR();
    #define PK(k) (bf16x8){lo[k][0],lo[k][1],lo[k][2],lo[k][3],hi[k][0],hi[k][1],hi[k][2],hi[k][3]}
    o[d0]=__builtin_amdgcn_mfma_f32_32x32x16_bf16(pa0,PK(0),o[d0],0,0,0);
    o[d0]=__builtin_amdgcn_mfma_f32_32x32x16_bf16(pa1,PK(1),o[d0],0,0,0);
    o[d0]=__builtin_amdgcn_mfma_f32_32x32x16_bf16(pa2,PK(2),o[d0],0,0,0);
    o[d0]=__builtin_amdgcn_mfma_f32_32x32x16_bf16(pa3,PK(3),o[d0],0,0,0);
    #undef PK
  }
}

#ifndef ATTN_STORE16
#define ATTN_STORE16(p,v) (*(u32x4*)(p)=(v))
#endif
template<int THRL> __device__ __forceinline__ void attn_unit(int b,int h,int qb,const bf16*Q,const bf16*__restrict__ K,const bf16*__restrict__ V,bf16*O,const float*__restrict__ LOGF,char*shm){
  const int tid=threadIdx.x,lane=tid&63,r32=lane&31,hi=lane>>5; const int wid=__builtin_amdgcn_readfirstlane(tid>>6);
  const long rowbase=(long)b*SEQ; const int q0=qb*QB;
  const bf16*Qw=Q+(rowbase+q0+wid*QBLK)*DM+h*D;
  const bf16*Kh=K+rowbase*DM+h*D,*Vh=V+rowbase*DM+h*D;
  const unsigned lds0=(unsigned)(uintptr_t)shm;
  float*wsf=(float*)(shm+LDS_WS)+wid*64;
  const bf16*ksrc=Kh+(long)lane*DM+wid*8;
  const bf16*vsrc=Vh+(long)(16*(wid&3)+(lane>>2))*DM+(wid>>2)*32+(lane&3)*8;
  const unsigned kdst=lds0+LDS_K+wid*1024, vdst=lds0+LDS_V+wid*1024;
  #define DMA_K(t,slot) glds16(ksrc+(long)(t)*KVBLK*DM,(unsigned)__builtin_amdgcn_readfirstlane(kdst+(slot)))
  #define DMA_V(t,slot) glds16(vsrc+(long)(t)*KVBLK*DM,(unsigned)__builtin_amdgcn_readfirstlane(vdst+(slot)))
  const int vb0=(int)(lds0+LDS_V)+((lane>>4)&1)*32+(lane&3)*8+(4*hi+((lane&15)>>2))*64;
  const char*Kbase=shm+LDS_K; bf16x8 kf[8];
  const lds_cptr shm3=(lds_cptr)shm; const lds_cptr kp0=shm3+LDS_K+hi*1024+r32*16; const lds_cptr vp0=shm3+LDS_V+((lane>>4)&1)*32+(lane&3)*8+(4*hi+((lane&15)>>2))*64;
  const int NT=(q0+QB)/KVBLK;
  typedef __attribute__((address_space(3))) float lds_f32; typedef __attribute__((address_space(3))) f32x4v lds_f32x4;
  { lds_f32* cbw=(lds_f32*)((__attribute__((address_space(3))) char*)shm+LDS_CB); lds_f32* wt=cbw+SEQ;
    const float* lf=LOGF+((long)b*NHEAD+h)*SEQ; const int s0=tid*8; f32x4v x0={0.f,0.f,0.f,0.f},x1={0.f,0.f,0.f,0.f};
    if(s0<q0+QB){x0=*(const f32x4v*)(lf+s0);x1=*(const f32x4v*)(lf+s0+4);}
    x0[1]+=x0[0];x0[2]+=x0[1];x0[3]+=x0[2];x1[0]+=x0[3];x1[1]+=x1[0];x1[2]+=x1[1];x1[3]+=x1[2];
    float tot=x1[3],inc=tot;
    #pragma unroll
    for(int o_=1;o_<64;o_<<=1){const float y=__shfl_up(inc,o_);if(lane>=o_)inc+=y;}
    if(lane==63)wt[wid]=inc;
    asm volatile("s_waitcnt lgkmcnt(0)\n\ts_barrier":::"memory");
    float off=inc-tot;
    #pragma unroll
    for(int w_=0;w_<NW;++w_){const float wv=wt[w_];if(w_<wid)off+=wv;}
    const float NL2E=-1.4426950408889634f;
    f32x4v y0,y1;
    #pragma unroll
    for(int j_=0;j_<4;++j_){y0[j_]=(x0[j_]+off)*NL2E;y1[j_]=(x1[j_]+off)*NL2E;}
    *(lds_f32x4*)(cbw+s0)=y0;*(lds_f32x4*)(cbw+s0+4)=y1;
    asm volatile("s_waitcnt lgkmcnt(0)\n\ts_barrier":::"memory"); }
  const lds_f32x4* cbp=(const lds_f32x4*)((__attribute__((address_space(3))) const char*)shm+LDS_CB)+hi;
  #define CBINIT(C0,C1,t,MH) do{ _Pragma("unroll") for(int g_=0;g_<4;++g_){ const f32x4v u0_=cbp[16*(t)+2*g_],u1_=cbp[16*(t)+8+2*g_]; \
      _Pragma("unroll") for(int j_=0;j_<4;++j_){C0[4*g_+j_]=u0_[j_]-(MH);C1[4*g_+j_]=u1_[j_]-(MH);} } }while(0)
  DMA_K(0,0);DMA_V(0,0);DMA_K(1,SLOTB);
  bf16x8 qr[4];
  #pragma unroll
  for(int d0=0;d0<4;++d0)qr[d0]=*reinterpret_cast<const bf16x8*>(&Qw[(long)r32*DM+d0*16+hi*8]);
  float mhat=0.f,l_reg=0.f;f32x16 o[2];o[0]=f32x16{};o[1]=f32x16{};
  const int qrel=wid*QBLK+r32;
  #define CMASK(P0,P1,t) do{int jb_=(t)-(NT-4); if(jb_>=0)cmask(P0,P1,jb_,qrel,hi);}while(0)
  bool resc=false;
  #define START(P0,P1) do{ const float rm=rowmax(P0,P1); resc=false; \
    { const float dl=rm; mhat=fadd_s(mhat,dl); \
      _Pragma("unroll") for(int r=0;r<16;++r){P0[r]=fsub_s(P0[r],dl);P1[r]=fsub_s(P1[r],dl);} \
      } \
    _Pragma("unroll") for(int r=0;r<16;++r)P0[r]=__builtin_amdgcn_exp2f(P0[r]); }while(0)
  #define RESC() do{ if(resc){ asm volatile("s_waitcnt lgkmcnt(0)":::"memory"); \
      _Pragma("unroll") for(int d_=0;d_<2;++d_) _Pragma("unroll") for(int r=0;r<16;++r)o[d_][r]*=wsf[crow(r,hi)]; } }while(0)
  f32x16 pA0,pA1,pB0,pB1;
  int sl_prev=0,sl_cur=0,sl_next=SLOTB;
  #define ROT() do{sl_prev=sl_cur;sl_cur=sl_next;sl_next=(sl_next==(NSLOT-1)*SLOTB)?0:sl_next+SLOTB;}while(0)
  DMA_K(2,2*SLOTB);
  WAIT_BAR(3);
  CBINIT(pA0,pA1,0,0.f); qkt(pA0,pA1,Kbase,qr,r32,hi);asm volatile("s_nop 15\n\ts_nop 7":"+v"(pA0),"+v"(pA1));CMASK(pA0,pA1,0);
  START(pA0,pA1);
  _Pragma("unroll") for(int r=0;r<16;++r)pA1[r]=__builtin_amdgcn_exp2f(pA1[r]);
  WAIT_BAR(0);
  DMA_K(3,0);DMA_V(1,SLOTB);
  ROT();
  kload8(kf,kp0+sl_cur);
  WAIT_BAR(2);
  s16x4 vlo[8],vhi[8]; u32x4 pw0,pw1,pw2,pw3;
  #define PKW(P,B) cvtpk_s(P[B],P[B+1])
  #define PAF(k) __builtin_bit_cast(bf16x8,pw##k)
  #define VFR(i) (bf16x8){vlo[i][0],vlo[i][1],vlo[i][2],vlo[i][3],vhi[i][0],vhi[i][1],vhi[i][2],vhi[i][3]}
  #define PIN(x) asm volatile("":"+v"(x))
  #define MX3(a,b,c) __builtin_fmaxf(__builtin_fmaxf((a),(b)),(c))
  #define GAPA(MF,A0,A1,A2,A3,W0,W1,PW) do{ MF; sacc+=A0; sacc+=A1; sacc+=A2; sacc+=A3; PIN(sacc); W0; W1; PIN(PW); SBAR(); }while(0)
  #define EX(v) __builtin_amdgcn_exp2f(v)
  #define GAPB(MF,X,B) do{ MF; X[B]=EX(X[B]); X[B+1]=EX(X[B+1]); X[B+2]=EX(X[B+2]); X[B+3]=EX(X[B+3]); PIN(X); SBAR(); }while(0)
  #define VRD(i) do{ vlo[i]=vtr(vp_+(((i)>>2)*4096+((i)&3)*1024)); vhi[i]=vtr(vp_+(((i)>>2)*4096+((i)&3)*1024+512)); }while(0)
  #define KRD(G,j) do{ if(G){ kload2(kf,kp0+sl_next,j); SBAR(); } }while(0)
  #define STEP(C0,C1,P0,P1,t,GK,GV,GL) do{ SBAR(); CBINIT(C0,C1,t,mhat); SBAR(); \
    const lds_cptr vp_=vp0+sl_prev; \
    VRD(0); SBAR(); float sacc=(P0[0]+P0[1]); \
    GAPA(C0=__builtin_amdgcn_mfma_f32_32x32x16_bf16(kf[0],qr[0],C0,0,0,0), P0[2],P0[3],P0[4],P0[5],     pw0[0]=PKW(P0,0), pw0[1]=PKW(P0,2), pw0); \
    VRD(4); SBAR(); GAPA(C1=__builtin_amdgcn_mfma_f32_32x32x16_bf16(kf[1],qr[0],C1,0,0,0), P0[6],P0[7],P0[8],P0[9],     pw0[2]=PKW(P0,4), pw0[3]=PKW(P0,6), pw0); \
    VRD(1); SBAR(); GAPA(C0=__builtin_amdgcn_mfma_f32_32x32x16_bf16(kf[2],qr[1],C0,0,0,0),   P0[10],P0[11],P0[12],P0[13], pw1[0]=PKW(P0,8), pw1[1]=PKW(P0,10), pw1); \
    VRD(5); SBAR(); GAPA(C1=__builtin_amdgcn_mfma_f32_32x32x16_bf16(kf[3],qr[1],C1,0,0,0),   P0[14],P0[15],P1[0],P1[1],   pw1[2]=PKW(P0,12),pw1[3]=PKW(P0,14), pw1); \
    VRD(2); SBAR(); GAPA(C0=__builtin_amdgcn_mfma_f32_32x32x16_bf16(kf[4],qr[2],C0,0,0,0),   P1[2],P1[3],P1[4],P1[5],     pw2[0]=PKW(P1,0), pw2[1]=PKW(P1,2), pw2); \
    VRD(6); SBAR(); GAPA(C1=__builtin_amdgcn_mfma_f32_32x32x16_bf16(kf[5],qr[2],C1,0,0,0),   P1[6],P1[7],P1[8],P1[9],     pw2[2]=PKW(P1,4), pw2[3]=PKW(P1,6), pw2); \
    VRD(3); SBAR(); GAPA(C0=__builtin_amdgcn_mfma_f32_32x32x16_bf16(kf[6],qr[3],C0,0,0,0),   P1[10],P1[11],P1[12],P1[13], pw3[0]=PKW(P1,8), pw3[1]=PKW(P1,10), pw3); \
    VRD(7); SBAR(); GAPA(C1=__builtin_amdgcn_mfma_f32_32x32x16_bf16(kf[7],qr[3],C1,0,0,0),   P1[14],P1[15],0.f,0.f,       pw3[2]=PKW(P1,12),pw3[3]=PKW(P1,14), pw3); \
    l_reg+=sacc; \
    if(GK){DMA_K((t)+3,sl_cur);} if(GV){DMA_V((t)+1,sl_next);} \
    CMASK(C0,C1,t); \
    { float a=MX3(C0[0],C0[1],C1[0]),b=MX3(C0[2],C0[3],C1[1]); a=MX3(a,C1[2],C1[3]); \
      _Pragma("unroll") for(int r=4;r<16;r+=4){a=MX3(a,C0[r],C0[r+1]);b=MX3(b,C0[r+2],C0[r+3]);a=MX3(a,C1[r],C1[r+1]);b=MX3(b,C1[r+2],C1[r+3]);} \
      float rm=__builtin_fmaxf(a,b); { auto rr=__builtin_amdgcn_permlane32_swap(__float_as_uint(rm),__float_as_uint(rm),false,false); rm=__builtin_fmaxf(__uint_as_float(rr[0]),__uint_as_float(rr[1])); } \
      resc=false; \
      if(__builtin_expect(__any(rm>(float)THRL),0)){ const float dl=__builtin_fmaxf(rm,0.f); mhat+=dl; \
        _Pragma("unroll") for(int r=0;r<16;++r){C0[r]-=dl;C1[r]-=dl;} \
        const float f=__builtin_amdgcn_exp2f(-dl); l_reg*=f; if(hi==0)wsf[r32]=f; resc=true; } } \
    SBAR(); \
    GAPB(o[0]=__builtin_amdgcn_mfma_f32_32x32x16_bf16(PAF(0),VFR(0),o[0],0,0,0), C0,0); \
    GAPB(o[1]=__builtin_amdgcn_mfma_f32_32x32x16_bf16(PAF(0),VFR(4),o[1],0,0,0), C0,4); \
    KRD(GL,0); GAPB(o[0]=__builtin_amdgcn_mfma_f32_32x32x16_bf16(PAF(1),VFR(1),o[0],0,0,0), C0,8); \
    KRD(GL,1); GAPB(o[1]=__builtin_amdgcn_mfma_f32_32x32x16_bf16(PAF(1),VFR(5),o[1],0,0,0), C0,12); \
    KRD(GL,2); GAPB(o[0]=__builtin_amdgcn_mfma_f32_32x32x16_bf16(PAF(2),VFR(2),o[0],0,0,0), C1,0); \
    KRD(GL,3); GAPB(o[1]=__builtin_amdgcn_mfma_f32_32x32x16_bf16(PAF(2),VFR(6),o[1],0,0,0), C1,4); \
    GAPB(o[0]=__builtin_amdgcn_mfma_f32_32x32x16_bf16(PAF(3),VFR(3),o[0],0,0,0), C1,8); \
    GAPB(o[1]=__builtin_amdgcn_mfma_f32_32x32x16_bf16(PAF(3),VFR(7),o[1],0,0,0), C1,12); \
    }while(0)
  int t=1;
  #undef CMASK
  #define CMASK(P0,P1,t) do{}while(0)
  for(;t+5<NT;t+=2){
    STEP(pB0,pB1,pA0,pA1,t,true,true,true);     WAIT_BAR(2); RESC(); ROT();
    STEP(pA0,pA1,pB0,pB1,t+1,true,true,true);   WAIT_BAR(2); RESC(); ROT();
  }
  #undef CMASK
  #define CMASK(P0,P1,t) do{int jb_=(t)-(NT-4); if(jb_>=0)cmask(P0,P1,jb_,qrel,hi);}while(0)
  #define ENDW(tt) do{ if((tt)+3<NT){WAIT_BAR(2);} else if((tt)+2<NT){WAIT_BAR(1);} else {WAIT_BAR(0);} }while(0)
  for(;t+1<NT;t+=2){
    STEP(pB0,pB1,pA0,pA1,t,(t+3<NT),(t+1<NT),(t+1<NT));       ENDW(t);   RESC(); ROT();
    STEP(pA0,pA1,pB0,pB1,t+1,(t+4<NT),(t+2<NT),(t+2<NT));     ENDW(t+1); RESC(); ROT();
  }
  STEP(pB0,pB1,pA0,pA1,NT-1,false,false,false); RESC();
  { float sacc=pB0[0]+pB0[1]; _Pragma("unroll") for(int r=2;r<16;++r)sacc+=pB0[r]; _Pragma("unroll") for(int r=0;r<16;++r)sacc+=pB1[r]; l_reg+=sacc;
    pw0=(u32x4){PKW(pB0,0),PKW(pB0,2),PKW(pB0,4),PKW(pB0,6)};pw1=(u32x4){PKW(pB0,8),PKW(pB0,10),PKW(pB0,12),PKW(pB0,14)};pw2=(u32x4){PKW(pB1,0),PKW(pB1,2),PKW(pB1,4),PKW(pB1,6)};pw3=(u32x4){PKW(pB1,8),PKW(pB1,10),PKW(pB1,12),PKW(pB1,14)};
    SBAR(); pv(o,vb0+sl_cur,PAF(0),PAF(1),PAF(2),PAF(3)); }
  #undef PKW
  #undef PAF
  #undef VFR
  #undef PIN
  #undef MX3
  #undef GAPA
  #undef GAPB
  #undef EX
  #undef VRD
  #undef KRD
  #undef STEP
  #undef ENDW
  {auto rr=__builtin_amdgcn_permlane32_swap(__float_as_uint(l_reg),__float_as_uint(l_reg),false,false);l_reg=__uint_as_float(rr[0])+__uint_as_float(rr[1]);}
  if(hi==0)wsf[32+r32]=l_reg;asm volatile("s_waitcnt lgkmcnt(0)":::"memory");
  float rli[16];
  #pragma unroll
  for(int r=0;r<16;++r)rli[r]=__builtin_amdgcn_rcpf(wsf[32+crow(r,hi)]);
  bf16*Ow=O+(rowbase+q0+wid*QBLK)*DM+h*D;
  { bf16*stg=(bf16*)(shm+LDS_OST)+wid*2048;
    #pragma unroll
    for(int r=0;r<16;++r){const int orow=crow(r,hi);
      #pragma unroll
      for(int d0=0;d0<2;++d0)stg[orow*64+d0*32+r32]=__float2bfloat16(o[d0][r]*rli[r]);}
    asm volatile("s_waitcnt lgkmcnt(0)":::"memory");
    #pragma unroll
    for(int i=0;i<4;++i){const int row=i*8+(lane>>3),ch=lane&7; const u32x4 v=*(const u32x4*)(stg+row*64+ch*8); ATTN_STORE16(Ow+(long)row*DM+ch*8,v);} }
  asm volatile("s_waitcnt lgkmcnt(0)\n\ts_barrier":::"memory");
  #undef DMA_K
  #undef CBINIT
  #undef DMA_V
  #undef CMASK
  #undef START
  #undef RESC
  #undef ROT
}
constexpr int ATTN_LDS_BYTES=LDS_BYTES;
struct AttnTensors { const bf16* Q; const bf16* K; const bf16* V; bf16* O; const float* LOGF; };
struct AttnUnit { int bh; int qb; };
struct StaticOrder {
  int vcu;
  __device__ __forceinline__ explicit StaticOrder(int grid,int block):vcu((block%8)*(grid/8)+block/8){}
  __device__ __forceinline__ bool next(int i,AttnUnit&u)const{ if(i>=8)return false; const int p=4*(vcu&1)+(i>>1); u.bh=vcu>>1; u.qb=(i&1)?15-p:p; return true; }
  __device__ __forceinline__ void a_ready(const AttnUnit&)const{}
  __device__ __forceinline__ void done(const AttnUnit&)const{}
};
template<class Sched,int THRL=8> __device__ __forceinline__ void attn_phase(char*lds,const AttnTensors&T,const Sched&S){
  AttnUnit u;
  for(int i=0;S.next(i,u);++i){ S.a_ready(u); attn_unit<THRL>(u.bh/NHEAD,u.bh%NHEAD,u.qb,T.Q,T.K,T.V,T.O,T.LOGF,lds); S.done(u); }
}
#undef SBAR
#undef WAIT_BAR
}
#include <hip/hip_cooperative_groups.h>
namespace cg = cooperative_groups;

#ifndef MK_N_LAUNCHES
#define MK_N_LAUNCHES 24
#endif
constexpr int NWAVES = 8;
constexpr int NPHASE = 24;
constexpr int BATCH = 8, SEQ = 4096, D = 1024, FF = 2816, RNN = 1344, RNP = 1408, NH = 16, NLB = 16, LB = 84;
constexpr int M = BATCH * SEQ;
constexpr float EPS = 1e-6f;
constexpr int CHUNK = 64, NCHUNK = SEQ / CHUNK;
constexpr size_t MiB = 1u << 20;
constexpr size_t WS_LOGF = 1 * MiB, WS_SUMM = 3 * MiB, WS_SP = 9 * MiB;
constexpr size_t WS_WF1 = 10 * MiB, WF1_SZ = (size_t)2 * FF * D * 2;
constexpr size_t WS_WF2 = 54 * MiB, WF2_SZ = (size_t)D * FF * 2;
constexpr size_t WS_WIN = 76 * MiB, WS_WG = 82 * MiB, WS_WOUT = 90 * MiB, WS_WKV = 93 * MiB, WS_WQ = 97 * MiB, WS_WO = 99 * MiB;
constexpr size_t WS_XN = 102 * MiB;
constexpr size_t WS_R1 = 166 * MiB;
constexpr size_t WS_G = WS_R1, WS_XC = WS_R1 + 88 * MiB, WS_Q = WS_R1, WS_XN2 = WS_R1 + 64 * MiB;
constexpr size_t WS_R2 = 342 * MiB;
constexpr size_t WS_F = WS_R2, WS_XR = WS_R2, WS_AU = WS_R2, WS_K = WS_R2, WS_V = WS_R2 + 64 * MiB;
constexpr size_t WS_END = 510 * MiB;
static_assert(WS_WF1 + 4 * WF1_SZ <= WS_WF2 && WS_WF2 + 4 * WF2_SZ <= WS_WIN && WS_WIN + (size_t)2816 * 1024 * 2 <= WS_WG && WS_WG + (size_t)2816 * 1408 * 2 <= WS_WOUT && WS_WOUT + (size_t)1024 * 1408 * 2 <= WS_WKV, "ws map (weights)");
static_assert(WS_R1 + (size_t)M * FF * 2 <= WS_R2 && WS_R2 + (size_t)M * RNN * 4 <= WS_END && WS_XN + (size_t)M * D * 2 <= WS_R1, "ws map");

constexpr int RING_BYTES = 131072, LDS_BYTES = 147456;
#define LAS __attribute__((address_space(3)))
typedef unsigned short bf16;
typedef unsigned v4u __attribute__((ext_vector_type(4)));
typedef unsigned v2u __attribute__((ext_vector_type(2)));
typedef float f32x4 __attribute__((ext_vector_type(4)));
typedef float f32x2 __attribute__((ext_vector_type(2)));

__device__ __forceinline__ unsigned f2bf(float f) { unsigned u = __builtin_bit_cast(unsigned, f); return (u + 0x7fffu + ((u >> 16) & 1u)) >> 16; }
__device__ __forceinline__ unsigned pk2(float lo, float hi) { return f2bf(lo) | (f2bf(hi) << 16); }
__device__ __forceinline__ float bflo(unsigned w) { return __uint_as_float(w << 16); }
__device__ __forceinline__ float bfhi(unsigned w) { return __uint_as_float(w & 0xffff0000u); }
__device__ __forceinline__ float sigmoidf_(float z) { return __builtin_amdgcn_rcpf(1.0f + __builtin_amdgcn_exp2f(-1.4426950408889634f * z)); }
__device__ __forceinline__ float wave_sum(float v) {
#pragma unroll
    for (int o = 1; o < 64; o <<= 1) v += __shfl_xor(v, o);
    return v;
}

namespace pg8 {
struct EpiSwiGLU {
    static constexpr bool PERM = true, AFTER_DRAIN = false;
    bf16_t* O; int ldc;
    __device__ __forceinline__ void operator()(const f32x4 (&acc)[2][2][4][2], const Unit& u, int wr, int wc, int fr, int fq) const {
        const int row0 = u.pm * BM + wr * 64 + fr, col0 = u.pn * HALF + wc * 32 + 8 * fq;
#pragma unroll
        for (int ai = 0; ai < 2; ++ai)
#pragma unroll
            for (int m = 0; m < 4; ++m) {
                float o[8];
#pragma unroll
                for (int n = 0; n < 2; ++n)
#pragma unroll
                    for (int j = 0; j < 4; ++j) { const float g = acc[ai][0][m][n][j], up = acc[ai][1][m][n][j]; o[4 * n + j] = g * sigmoidf_(g) * up; }
                u32x4 w; w.x = cvt_pk_bf16(o[0], o[1]); w.y = cvt_pk_bf16(o[2], o[3]); w.z = cvt_pk_bf16(o[4], o[5]); w.w = cvt_pk_bf16(o[6], o[7]);
                *(u32x4*)(O + (size_t)(row0 + ai * HALF + m * 16) * ldc + col0) = w;
            }
    }
};
struct EpiF32 {
    static constexpr bool PERM = false, AFTER_DRAIN = false;
    float* O; int ldc;
    __device__ __forceinline__ void operator()(const f32x4 (&acc)[2][2][4][2], const Unit& u, int wr, int wc, int fr, int fq) const {
        const int row0 = u.pm * BM + wr * 64 + fr, col0 = u.pn * BM + wc * 32 + 4 * fq;
#pragma unroll
        for (int ai = 0; ai < 2; ++ai)
#pragma unroll
            for (int m = 0; m < 4; ++m) { float* rowp = O + (size_t)(row0 + ai * HALF + m * 16) * ldc + col0;
#pragma unroll
                for (int bj = 0; bj < 2; ++bj)
#pragma unroll
                    for (int n = 0; n < 2; ++n) *(f32x4*)(rowp + bj * HALF + n * 16) = acc[ai][bj][m][n]; }
    }
};
struct EpiGR {
    static constexpr bool PERM = true, AFTER_DRAIN = false;
    bf16_t* G; bf16_t* XR;
    __device__ __forceinline__ void operator()(const f32x4 (&acc)[2][2][4][2], const Unit& u, int wr, int wc, int fr, int fq) const {
        const int row0 = u.pm * BM + wr * 64 + fr;
#pragma unroll
        for (int bj = 0; bj < 2; ++bj) {
            const int hidx = 2 * u.pn + bj; const bool act = hidx < 11;
            bf16_t* base = act ? G + hidx * HALF : XR + (hidx - 11) * HALF; const int col0 = wc * 32 + 8 * fq;
#pragma unroll
            for (int ai = 0; ai < 2; ++ai)
#pragma unroll
                for (int m = 0; m < 4; ++m) {
                    float o[8];
#pragma unroll
                    for (int n = 0; n < 2; ++n)
#pragma unroll
                        for (int j = 0; j < 4; ++j) { const float x = acc[ai][bj][m][n][j]; const float gl = x * __builtin_amdgcn_rcpf(1.0f + __builtin_amdgcn_exp2f(-2.3022082f * (x + 0.044715f * x * x * x))); o[4 * n + j] = act ? gl : x; }
                    u32x4 w; w.x = cvt_pk_bf16(o[0], o[1]); w.y = cvt_pk_bf16(o[2], o[3]); w.z = cvt_pk_bf16(o[4], o[5]); w.w = cvt_pk_bf16(o[6], o[7]);
                    *(u32x4*)(base + (size_t)(row0 + ai * HALF + m * 16) * 1408 + col0) = w;
                }
        }
    }
};
struct EpiGates {
    static constexpr bool PERM = true, AFTER_DRAIN = false;
    const bf16_t* XC; unsigned* AU; const float* ba; const float* bx; const float* sp8;
    __device__ __forceinline__ void operator()(const f32x4 (&acc)[2][2][4][2], const Unit& u, int wr, int wc, int fr, int fq) const {
        const int row0 = u.pm * BM + wr * 64 + fr, ch0 = u.pn * HALF + wc * 32 + 8 * fq;
        if (ch0 >= 1344) return;
        float pba[8], pbx[8], psp[8];
#pragma unroll
        for (int j = 0; j < 8; ++j) { pba[j] = ba[ch0 + j]; pbx[j] = bx[ch0 + j]; psp[j] = sp8[ch0 + j]; }
#pragma unroll
        for (int ai = 0; ai < 2; ++ai)
#pragma unroll
            for (int m = 0; m < 4; ++m) {
                const size_t row = (size_t)(row0 + ai * HALF + m * 16);
                const u32x4 xw = *(const u32x4*)(XC + row * 1408 + ch0);
                float xc[8]; xc[0] = __uint_as_float(xw.x << 16); xc[1] = __uint_as_float(xw.x & 0xffff0000u); xc[2] = __uint_as_float(xw.y << 16); xc[3] = __uint_as_float(xw.y & 0xffff0000u);
                xc[4] = __uint_as_float(xw.z << 16); xc[5] = __uint_as_float(xw.z & 0xffff0000u); xc[6] = __uint_as_float(xw.w << 16); xc[7] = __uint_as_float(xw.w & 0xffff0000u);
                unsigned o[8];
#pragma unroll
                for (int n = 0; n < 2; ++n)
#pragma unroll
                    for (int j = 0; j < 4; ++j) { const int c = 4 * n + j;
                        const float r = sigmoidf_(acc[ai][0][m][n][j] + pba[c]), ig = sigmoidf_(acc[ai][1][m][n][j] + pbx[c]);
                        const float la = -psp[c] * r, x2 = 2.0f * la;
                        const float em1 = -x2 * (1.0f + x2 * (0.5f + x2 * (0.16666667f + x2 * (0.041666668f + x2 * 0.0083333333f))));
                        const float uu = __builtin_sqrtf(__builtin_fmaxf(em1, 0.f)) * (ig * xc[c]);
                        const unsigned short hl = __builtin_bit_cast(unsigned short, (_Float16)la), hu = __builtin_bit_cast(unsigned short, (_Float16)uu);
                        o[c] = (unsigned)hl | ((unsigned)hu << 16); }
                unsigned* dst = AU + row * 1344 + ch0;
                *(u32x4*)dst = (u32x4){o[0], o[1], o[2], o[3]}; *(u32x4*)(dst + 4) = (u32x4){o[4], o[5], o[6], o[7]};
            }
    }
};
}

__device__ __forceinline__ void tr_item(const float* W, int N, bf16* WT, int ldt, const float* gk, int mode, int row_off, LAS float* scr, int item, int lane) {
    const int nblk = N / 32, kb = item / nblk, nb = item % nblk, k0 = 64 * kb, n0 = 32 * nb;
#pragma unroll 8
    for (int i = 0; i < 32; ++i) { const int kk = 2 * i + (lane >> 5); scr[kk * 33 + (lane & 31)] = W[(size_t)(k0 + kk) * N + n0 + (lane & 31)] * (gk ? gk[k0 + kk] : 1.0f); }
    asm volatile("s_waitcnt lgkmcnt(0)" ::: "memory");
    const int c = lane & 7;
    int r0 = n0;
    if (mode == 1) r0 = (n0 >> 7) * 256 + (n0 & 127); else if (mode == 2) r0 = (n0 >> 7) * 256 + 128 + (n0 & 127); else if (mode == 3) r0 = n0 >= 1344 ? n0 + 64 : n0; else r0 = n0 + row_off;
#pragma unroll
    for (int j = 0; j < 4; ++j) { const int n = (lane >> 3) + 8 * j; const LAS float* s = scr + (8 * c) * 33 + n;
        v4u o; o.x = pk2(s[0 * 33], s[1 * 33]); o.y = pk2(s[2 * 33], s[3 * 33]); o.z = pk2(s[4 * 33], s[5 * 33]); o.w = pk2(s[6 * 33], s[7 * 33]);
        *(v4u*)(WT + (size_t)(r0 + n) * ldt + k0 + 8 * c) = o; }
    asm volatile("s_waitcnt lgkmcnt(0)" ::: "memory");
}

struct Args { const float* in[28]; float* out; unsigned char* ws; int ph_lo, ph_hi; };

typedef __attribute__((address_space(4))) const Args CArgsP;
__device__ __forceinline__ void p_prologue(CArgsP* ap, LAS unsigned char* lds, int gw, int NGW, int lane, int wave) {
#define a (*ap)
    LAS float* scr = (LAS float*)(lds + wave * 16384);
    unsigned char* ws = a.ws;
    constexpr int I_GU = (D / 64) * (FF / 32), I_DN = (FF / 64) * (D / 32);
    constexpr int I_IN = (D / 64) * (2 * RNN / 32), I_OUT = (RNN / 64) * (D / 32), I_KV = (D / 64) * (2 * D / 32), I_Q = (D / 64) * (D / 32);
    constexpr int N_FFN = 4 * (2 * I_GU + I_DN);
    constexpr int NITEMS = N_FFN + I_IN + I_OUT + I_KV + 2 * I_Q;
    for (int it = gw; it < NITEMS; it += NGW) {
        int r = it;
        if (r < N_FFN) {
            const int f = r / (2 * I_GU + I_DN), q = r % (2 * I_GU + I_DN), l = f >> 1, which = f & 1;
            const float* pre_g = a.in[which ? 8 : 1] + (size_t)l * D;
            const float* wg = a.in[which ? 9 : 2] + (size_t)l * D * FF; const float* wu = a.in[which ? 10 : 3] + (size_t)l * D * FF; const float* wd = a.in[which ? 11 : 4] + (size_t)l * FF * D;
            bf16* w1 = (bf16*)(ws + WS_WF1 + (size_t)f * WF1_SZ); bf16* w2 = (bf16*)(ws + WS_WF2 + (size_t)f * WF2_SZ);
            if (q < I_GU) tr_item(wg, FF, w1, D, pre_g, 1, 0, scr, q, lane);
            else if (q < 2 * I_GU) tr_item(wu, FF, w1, D, pre_g, 2, 0, scr, q - I_GU, lane);
            else tr_item(wd, D, w2, FF, nullptr, 0, 0, scr, q - 2 * I_GU, lane);
            continue;
        }
        r -= N_FFN;
        if (r < I_IN) { tr_item(a.in[13], 2 * RNN, (bf16*)(ws + WS_WIN), D, a.in[6], 3, 0, scr, r, lane); continue; } r -= I_IN;
        if (r < I_OUT) { tr_item(a.in[21], D, (bf16*)(ws + WS_WOUT), RNP, nullptr, 0, 0, scr, r, lane); continue; } r -= I_OUT;
        if (r < I_KV) { tr_item(a.in[23], 2 * D, (bf16*)(ws + WS_WKV), D, a.in[22], 0, 0, scr, r, lane); continue; } r -= I_KV;
        if (r < I_Q) { tr_item(a.in[26], D, (bf16*)(ws + WS_WQ), D, a.in[6] + D, 0, 0, scr, r, lane); continue; } r -= I_Q;
        tr_item(a.in[27], D, (bf16*)(ws + WS_WO), D, nullptr, 0, 0, scr, r, lane);
    }
    const int gt = gw * 64 + lane, NGT = NGW * 64;
    for (int i = gt; i < 128 * 128; i += NGT) { const int rr = i / 128, cc = i % 128; const int row = rr < 64 ? 1344 + rr : 2752 + (rr - 64);
        *(v4u*)((bf16*)(ws + WS_WIN) + (size_t)row * D + cc * 8) = (v4u){0u, 0u, 0u, 0u}; }
    for (int i = gt; i < 1024 * 8; i += NGT) { const int row = i / 8, cc = i % 8; *(v4u*)((bf16*)(ws + WS_WOUT) + (size_t)row * RNP + RNN + cc * 8) = (v4u){0u, 0u, 0u, 0u}; }
    for (int i = gt; i < 2816 * (RNP / 2); i += NGT) { const int row = i / (RNP / 2), kp = (i % (RNP / 2)) * 2;
        const int s = (row >> 7) & 1, ch = (row >> 8) * 128 + (row & 127); float v[2] = {0.f, 0.f};
        if (ch < RNN) { const int blk = ch / LB, d = ch % LB; const float* w = a.in[s ? 18 : 16] + (size_t)blk * LB * LB;
#pragma unroll
            for (int e = 0; e < 2; ++e) { const int k = kp + e; if (k >= blk * LB && k < (blk + 1) * LB) v[e] = w[(k - blk * LB) * LB + d]; } }
        *(unsigned*)((bf16*)(ws + WS_WG) + (size_t)row * RNP + kp) = pk2(v[0], v[1]); }
    for (int i = gt; i < RNN; i += NGT) ((float*)(ws + WS_SP))[i] = 8.0f * log1pf(expf(-a.in[20][i]));
    for (int m = gw; m < M; m += NGW) {
        const f32x4* xr = (const f32x4*)(a.in[0] + (size_t)m * D) + lane; f32x4 v[4]; float s = 0.f;
#pragma unroll
        for (int j = 0; j < 4; ++j) { v[j] = xr[64 * j]; s += (v[j].x * v[j].x + v[j].y * v[j].y) + (v[j].z * v[j].z + v[j].w * v[j].w); }
        const float rstd = 1.0f / sqrtf(wave_sum(s) * (1.0f / D) + EPS);
        v2u* o8 = (v2u*)((bf16*)(ws + WS_XN) + (size_t)m * D) + lane;
#pragma unroll
        for (int j = 0; j < 4; ++j) o8[64 * j] = (v2u){pk2(v[j].x * rstd, v[j].y * rstd), pk2(v[j].z * rstd, v[j].w * rstd)};
    }
}

#undef a
__device__ __forceinline__ void p_row(const float* F, const float* base, float* out, bf16* XNo, const float* gpost, float coef,
                                      bool logf, const float* wf, const float* gkv, const float* bfg, float* LOGF,
                                      LAS unsigned char* lds, int gw, int NGW, int lane, int wave, int tid) {
    LAS float* wl = (LAS float*)lds;
    LAS float* hrow = (LAS float*)(lds + 65536) + wave * 1024;
    if (logf) {
        for (int i = tid; i < 1024 * 16; i += NWAVES * 64) wl[i] = wf[i] * gkv[i >> 4];
        __syncthreads();
    }
    f32x4 g[4];
#pragma unroll
    for (int j = 0; j < 4; ++j) g[j] = *((const f32x4*)gpost + lane + 64 * j);
    for (int m = gw; m < M; m += NGW) {
        const f32x4* fr = (const f32x4*)(F + (size_t)m * D) + lane; const f32x4* br = (const f32x4*)(base + (size_t)m * D) + lane;
        f32x4 v[4], h[4]; float s = 0.f;
#pragma unroll
        for (int j = 0; j < 4; ++j) { v[j] = fr[64 * j]; h[j] = br[64 * j]; s += (v[j].x * v[j].x + v[j].y * v[j].y) + (v[j].z * v[j].z + v[j].w * v[j].w); }
        const float rstd = coef / sqrtf(wave_sum(s) * (1.0f / D) + EPS);
        float s2 = 0.f;
#pragma unroll
        for (int j = 0; j < 4; ++j) { h[j] = h[j] + v[j] * g[j] * rstd; s2 += (h[j].x * h[j].x + h[j].y * h[j].y) + (h[j].z * h[j].z + h[j].w * h[j].w); }
        f32x4* orow = (f32x4*)(out + (size_t)m * D) + lane;
#pragma unroll
        for (int j = 0; j < 4; ++j) orow[64 * j] = h[j];
        if (XNo) {
            const float r2 = 1.0f / sqrtf(wave_sum(s2) * (1.0f / D) + EPS);
            v2u* o8 = (v2u*)(XNo + (size_t)m * D) + lane;
#pragma unroll
            for (int j = 0; j < 4; ++j) { h[j] = h[j] * r2; o8[64 * j] = (v2u){pk2(h[j].x, h[j].y), pk2(h[j].z, h[j].w)}; }
            if (logf) {
#pragma unroll
                for (int j = 0; j < 4; ++j) *((LAS f32x4*)hrow + lane + 64 * j) = h[j];
                asm volatile("s_waitcnt lgkmcnt(0)" ::: "memory");
                const int hj = lane & 15, q = lane >> 4; float z = 0.f;
#pragma unroll 8
                for (int kk = 0; kk < 256; ++kk) z += hrow[4 * kk + q] * wl[(4 * kk + q) * 16 + hj];
                z += __shfl_xor(z, 16); z += __shfl_xor(z, 32);
                if (lane < 16) { z += bfg[hj]; const float ls = fminf(z, 0.f) - log1pf(expf(-fabsf(z))); LOGF[((size_t)(m / SEQ) * NH + hj) * SEQ + (m % SEQ)] = ls; }
                asm volatile("s_waitcnt lgkmcnt(0)" ::: "memory");
            }
        }
    }
}

__device__ __forceinline__ void p_conv(const bf16* XR, bf16* XC, const float* cw, const float* cb, int gt, int NGT) {
    constexpr int RUN = 32, NCC = RNP / 8;
    for (int idx = gt; idx < (M / RUN) * NCC; idx += NGT) {
        const int cc = idx % NCC, rr = idx / NCC, t0 = rr * RUN, ch0 = cc * 8;
        if (cc >= RNN / 8) { for (int t = 0; t < RUN; ++t) *(v4u*)(XC + (size_t)(t0 + t) * RNP + ch0) = (v4u){0u, 0u, 0u, 0u}; continue; }
        float w[4][8], b[8], x0[8], x1[8], x2[8];
#pragma unroll
        for (int j = 0; j < 8; ++j) { b[j] = cb[ch0 + j];
#pragma unroll
            for (int k = 0; k < 4; ++k) w[k][j] = cw[k * RNN + ch0 + j]; }
        const bool first = (t0 % SEQ) == 0;
#define LD8(dst, row) do { const v4u q_ = *(const v4u*)(XR + (size_t)(row) * RNP + ch0); dst[0] = bflo(q_.x); dst[1] = bfhi(q_.x); dst[2] = bflo(q_.y); dst[3] = bfhi(q_.y); dst[4] = bflo(q_.z); dst[5] = bfhi(q_.z); dst[6] = bflo(q_.w); dst[7] = bfhi(q_.w); } while (0)
        if (first) {
#pragma unroll
            for (int j = 0; j < 8; ++j) { x0[j] = 0.f; x1[j] = 0.f; x2[j] = 0.f; }
        } else { LD8(x0, t0 - 3); LD8(x1, t0 - 2); LD8(x2, t0 - 1); }
#pragma unroll 4
        for (int t = 0; t < RUN; ++t) {
            float x3[8]; LD8(x3, t0 + t); float y[8];
#pragma unroll
            for (int j = 0; j < 8; ++j) { y[j] = b[j] + w[0][j] * x0[j] + w[1][j] * x1[j] + w[2][j] * x2[j] + w[3][j] * x3[j]; x0[j] = x1[j]; x1[j] = x2[j]; x2[j] = x3[j]; }
            *(v4u*)(XC + (size_t)(t0 + t) * RNP + ch0) = (v4u){pk2(y[0], y[1]), pk2(y[2], y[3]), pk2(y[4], y[5]), pk2(y[6], y[7])};
        }
#undef LD8
    }
}

__device__ __forceinline__ void au_unpack(unsigned w, float& la, float& u) {
    la = (float)__builtin_bit_cast(_Float16, (unsigned short)(w & 0xffffu)); u = (float)__builtin_bit_cast(_Float16, (unsigned short)(w >> 16));
}
__device__ __forceinline__ void p_scan1(const unsigned* AU, f32x2* SUMM, int gw, int NGW, int lane) {
    constexpr int NCG = RNN / 64;
    for (int idx = gw; idx < BATCH * NCHUNK * NCG; idx += NGW) {
        const int cgp = idx % NCG, ck = (idx / NCG) % NCHUNK, b = idx / (NCG * NCHUNK), ch = cgp * 64 + lane;
        const unsigned* p = AU + ((size_t)b * SEQ + (size_t)ck * CHUNK) * RNN + ch;
        float h = 0.f, sl = 0.f;
#pragma unroll 16
        for (int t = 0; t < CHUNK; ++t) { float la, u; au_unpack(p[(size_t)t * RNN], la, u); sl += la; h = __builtin_amdgcn_exp2f(la * 1.4426950408889634f) * h + u; }
        SUMM[((size_t)b * NCHUNK + ck) * RNN + ch] = (f32x2){__builtin_amdgcn_exp2f(sl * 1.4426950408889634f), h};
    }
}
__device__ __forceinline__ void p_scan3(const unsigned* AU, const f32x2* SUMM, bf16* G, int gw, int NGW, int lane) {
    constexpr int NCG = RNN / 64;
    for (int idx = gw; idx < BATCH * NCHUNK * NCG; idx += NGW) {
        const int cgp = idx % NCG, ck = (idx / NCG) % NCHUNK, b = idx / (NCG * NCHUNK), ch = cgp * 64 + lane;
        float h = 0.f;
        const f32x2* sp = SUMM + (size_t)b * NCHUNK * RNN + ch;
        for (int j = 0; j < ck; ++j) { const f32x2 s = sp[(size_t)j * RNN]; h = s.x * h + s.y; }
        const size_t row0 = (size_t)b * SEQ + (size_t)ck * CHUNK;
        const unsigned* p = AU + row0 * RNN + ch; bf16* gp = G + row0 * RNP + ch;
#pragma unroll 16
        for (int t = 0; t < CHUNK; ++t) { float la, u; au_unpack(p[(size_t)t * RNN], la, u); h = __builtin_amdgcn_exp2f(la * 1.4426950408889634f) * h + u;
            const float g = __uint_as_float((unsigned)gp[(size_t)t * RNP] << 16); gp[(size_t)t * RNP] = (bf16)f2bf(g * h); }
    }
}

typedef __attribute__((address_space(4))) const Args CArgs;
#define ARGS() ({ CArgs* p_ = (CArgs*)__builtin_amdgcn_kernarg_segment_ptr(); asm volatile("" : "+s"(p_)); p_; })
__global__ void __launch_bounds__(NWAVES * 64, 2) mk_fwd(Args args_unused) {
    extern __shared__ __attribute__((aligned(16))) unsigned char lds_raw[];
    LAS unsigned char* lds = (LAS unsigned char*)lds_raw;
#define tid ((int)threadIdx.x)
#define lane (tid & 63)
#define wave __builtin_amdgcn_readfirstlane(tid >> 6)
#define GG ((int)gridDim.x)
#define BX ((int)blockIdx.x)
#define GW (BX * NWAVES + wave)
#define NGW_ (GG * NWAVES)
#define IN(k) ({ CArgs* q_ = ARGS(); q_->ph_lo <= (k) && (k) < q_->ph_hi; })
#if MK_N_LAUNCHES == 1
#define SEAM(k) do { if (IN(k) && IN((k) + 1)) { __threadfence(); cg::this_grid().sync(); __threadfence(); } } while (0)
#else
#define SEAM(k) do { } while (0)
#endif
#define GEMM_PHASE(EPI, Aptr, Bptr, Nn, Kk, LDA, LDB, E) do { pg8::Gemm g_{(const pg8::bf16_t*)(Aptr), (const pg8::bf16_t*)(Bptr), M, (Nn), (Kk), (LDA), (LDB)}; pg8::StaticOrder S_; S_.init(M, (Nn), GG, BX); \
        pg8::gemm_phase<EPI, pg8::StaticOrder, true, true>(lds, g_, S_, E); } while (0)
#define FFN1(k, f) do { if (IN(k)) { unsigned char* ws = ARGS()->ws; pg8::EpiSwiGLU E_{(pg8::bf16_t*)(ws + WS_R1), FF}; GEMM_PHASE(pg8::EpiSwiGLU, ws + WS_XN, ws + WS_WF1 + (size_t)(f) * WF1_SZ, 2 * FF, D, D, D, E_); } SEAM(k); } while (0)
#define FFN2(k, f) do { if (IN(k)) { unsigned char* ws = ARGS()->ws; pg8::EpiF32 E_{(float*)(ws + WS_F), D}; GEMM_PHASE(pg8::EpiF32, ws + WS_R1, ws + WS_WF2 + (size_t)(f) * WF2_SZ, D, FF, FF, FF, E_); } SEAM(k); } while (0)
#define ROWP(k, BASE_IN, XNOFF, gidx, goff, coef, lf) do { if (IN(k)) { CArgs* A = ARGS(); unsigned char* ws = A->ws; \
        p_row((const float*)(ws + WS_F), (BASE_IN) ? A->in[0] : (const float*)A->out, A->out, (bf16*)(ws + (XNOFF)), A->in[gidx] + (goff), coef, lf, A->in[24], A->in[22], A->in[25], (float*)(ws + WS_LOGF), lds, GW, NGW_, lane, wave, tid); } SEAM(k); } while (0)

    if (IN(0)) p_prologue(ARGS(), lds, GW, NGW_, lane, wave);
    SEAM(0);
    FFN1(1, 0); FFN2(2, 0);
    ROWP(3, true, WS_XN, 5, 0, 0.5f, false);
    if (IN(4)) { unsigned char* ws = ARGS()->ws; pg8::EpiGR E_{(pg8::bf16_t*)(ws + WS_G), (pg8::bf16_t*)(ws + WS_XR)}; GEMM_PHASE(pg8::EpiGR, ws + WS_XN, ws + WS_WIN, 2816, D, D, D, E_); }
    SEAM(4);
    if (IN(5)) { CArgs* A = ARGS(); unsigned char* ws = A->ws; p_conv((const bf16*)(ws + WS_XR), (bf16*)(ws + WS_XC), A->in[14], A->in[15], BX * NWAVES * 64 + tid, NGW_ * 64); }
    SEAM(5);
    if (IN(6)) { CArgs* A = ARGS(); unsigned char* ws = A->ws; pg8::EpiGates E_{(const pg8::bf16_t*)(ws + WS_XC), (unsigned*)(ws + WS_AU), A->in[17], A->in[19], (const float*)(ws + WS_SP)};
        GEMM_PHASE(pg8::EpiGates, ws + WS_XC, ws + WS_WG, 2816, RNP, RNP, RNP, E_); }
    SEAM(6);
    if (IN(7)) { unsigned char* ws = ARGS()->ws; p_scan1((const unsigned*)(ws + WS_AU), (f32x2*)(ws + WS_SUMM), GW, NGW_, lane); }
    SEAM(7);
    if (IN(8)) { unsigned char* ws = ARGS()->ws; p_scan3((const unsigned*)(ws + WS_AU), (const f32x2*)(ws + WS_SUMM), (bf16*)(ws + WS_G), GW, NGW_, lane); }
    SEAM(8);
    if (IN(9)) { unsigned char* ws = ARGS()->ws; pg8::EpiF32 E_{(float*)(ws + WS_F), D}; GEMM_PHASE(pg8::EpiF32, ws + WS_G, ws + WS_WOUT, D, RNP, RNP, RNP, E_); }
    SEAM(9);
    ROWP(10, false, WS_XN, 7, 0, 1.0f, false);
    FFN1(11, 1); FFN2(12, 1);
    ROWP(13, false, WS_XN, 12, 0, 0.5f, true);
    FFN1(14, 2); FFN2(15, 2);
    ROWP(16, false, WS_XN2, 5, D, 0.5f, false);
    if (IN(17)) {
        { unsigned char* ws = ARGS()->ws; pg8::EpiBf16<0> E_{(pg8::bf16_t*)(ws + WS_Q), D, nullptr, D, 0, attn_body::C2}; pg8::Gemm g_{(const pg8::bf16_t*)(ws + WS_XN2), (const pg8::bf16_t*)(ws + WS_WQ), M, D, D, D, D}; pg8::StaticOrder S_; S_.init(M, D, GG, BX);
          pg8::gemm_phase<pg8::EpiBf16<0>, pg8::StaticOrder, true, true>(lds, g_, S_, E_); }
        { unsigned char* ws = ARGS()->ws; pg8::EpiBf16<0> E_{(pg8::bf16_t*)(ws + WS_K), D, nullptr, D, (size_t)(WS_V - WS_K) / 2, 1.0f}; pg8::Gemm g_{(const pg8::bf16_t*)(ws + WS_XN), (const pg8::bf16_t*)(ws + WS_WKV), M, 2 * D, D, D, D}; pg8::StaticOrder S_; S_.init(M, 2 * D, GG, BX);
          pg8::gemm_phase<pg8::EpiBf16<0>, pg8::StaticOrder, true, true>(lds, g_, S_, E_); }
    }
    SEAM(17);
    if (IN(18)) {
        static_assert(attn_body::ATTN_LDS_BYTES <= RING_BYTES, "attention LDS");
        unsigned char* ws = ARGS()->ws;
        const attn_body::AttnTensors AT{(const attn_body::bf16*)(ws + WS_Q), (const attn_body::bf16*)(ws + WS_K), (const attn_body::bf16*)(ws + WS_V), (attn_body::bf16*)(ws + WS_Q), (const float*)(ws + WS_LOGF)};
        const attn_body::StaticOrder S(GG, BX);
        attn_body::attn_phase<attn_body::StaticOrder>((char*)lds_raw, AT, S);
    }
    SEAM(18);
    if (IN(19)) { unsigned char* ws = ARGS()->ws; pg8::EpiF32 E_{(float*)(ws + WS_F), D}; GEMM_PHASE(pg8::EpiF32, ws + WS_Q, ws + WS_WO, D, D, D, D, E_); }
    SEAM(19);
    ROWP(20, false, WS_XN, 7, D, 1.0f, false);
    FFN1(21, 3); FFN2(22, 3);
    if (IN(23)) { CArgs* A = ARGS(); p_row((const float*)(A->ws + WS_F), (const float*)A->out, A->out, nullptr, A->in[12] + D, 0.5f, false, nullptr, nullptr, nullptr, nullptr, lds, GW, NGW_, lane, wave, tid); }
}

#undef tid
#undef lane
#undef wave
extern "C" void kernel_launch(void* const* d_in, const int* in_sizes, int n_in, void* d_out, int out_size, void* d_ws, size_t ws_size, hipStream_t stream) {
    static int grid = 0;
    if (grid == 0) {
        if (n_in != 28 || in_sizes[0] != M * D || out_size != M * D || ws_size < WS_END) { fprintf(stderr, "kernel_launch: unexpected shapes (n_in %d, in0 %d, out %d, ws %zu)\n", n_in, n_in > 0 ? in_sizes[0] : -1, out_size, ws_size); grid = -1; return; }
        int dev = 0, cus = 0, per_cu = 0;
        hipGetDevice(&dev); hipDeviceGetAttribute(&cus, hipDeviceAttributeMultiprocessorCount, dev);
        if (hipFuncSetAttribute((const void*)mk_fwd, hipFuncAttributeMaxDynamicSharedMemorySize, LDS_BYTES) != hipSuccess) { fprintf(stderr, "hipFuncSetAttribute failed\n"); grid = -1; return; }
        hipOccupancyMaxActiveBlocksPerMultiprocessor(&per_cu, (const void*)mk_fwd, NWAVES * 64, LDS_BYTES);
        (void)hipGetLastError();
        if (per_cu < 1) per_cu = 1;
        grid = cus * per_cu;
        if (grid > 256) grid = 256;
    }
    if (grid < 0) return;
    Args a{};
    for (int i = 0; i < 28; ++i) a.in[i] = (const float*)d_in[i];
    a.out = (float*)d_out; a.ws = (unsigned char*)d_ws;
#if MK_N_LAUNCHES == 1
    a.ph_lo = 0; a.ph_hi = NPHASE;
    void* kargs[] = {&a};
    hipError_t e = hipLaunchCooperativeKernel((const void*)mk_fwd, dim3(grid), dim3(NWAVES * 64), kargs, LDS_BYTES, stream);
    if (e != hipSuccess) fprintf(stderr, "cooperative launch failed: %s (grid %d)\n", hipGetErrorString(e), grid);
#else
    for (int p = 0; p < NPHASE; ++p) { a.ph_lo = p; a.ph_hi = p + 1; hipLaunchKernelGGL(mk_fwd, dim3(grid), dim3(NWAVES * 64), LDS_BYTES, stream, a); }
#endif
}
```
